# Optimizing an MI355X kernel written in HIP

```python
import math
import jax, jax.numpy as jnp
from jax import lax
import numpy as np

D_MODEL = 4096
BATCH = 2
SEQ = 8192
DEPTH = 1
DEC_BATCH = 2
DEC_SEQ = 4096
PAST_LEN = 128

HEAD_DIM = 128
N_HEADS = 16
ATTN_WIDTH = N_HEADS * HEAD_DIM
DILATED_PATTERNS = ((128, 1), (512, 4), (2048, 16))
SIDE_KEYS = 64
BLK = SIDE_KEYS
N_BUCKETS = 32
REL_MAX_DIST = 1024
NEG = -1e30
SSM_WIDTH = 2048
SSM_GROUP = 16
SSM_GROUPS = SSM_WIDTH // SSM_GROUP
SSM_STATE = 64
SSM_CHUNK = 128
DT_MIN = 0.001
DT_MAX = 0.1
EPS = 1e-6
IN_WIDTH = 4 * ATTN_WIDTH + 2 * SSM_WIDTH + 2 * D_MODEL
SPLITS = [ATTN_WIDTH, 2 * ATTN_WIDTH, 3 * ATTN_WIDTH, 4 * ATTN_WIDTH,
          4 * ATTN_WIDTH + SSM_WIDTH, 4 * ATTN_WIDTH + 2 * SSM_WIDTH,
          4 * ATTN_WIDTH + 2 * SSM_WIDTH + D_MODEL]

kernel_name = "hybrid_dilated_attn_s5_gated_encoder"


def _rmsnorm(x, g):
    xf = x.astype(jnp.float32)
    y = xf * lax.rsqrt(jnp.mean(xf * xf, axis=-1, keepdims=True) + EPS)
    return (y * g.astype(jnp.float32)).astype(x.dtype)


def _head_rms(t, g):
    tf = t.astype(jnp.float32)
    return tf * lax.rsqrt(jnp.mean(tf * tf, axis=-1, keepdims=True) + EPS) * g.astype(jnp.float32)


def _rel_bucket(rel):
    half = N_BUCKETS // 2
    exact = half // 2
    base = jnp.where(rel > 0, half, 0)
    n = jnp.abs(rel)
    nf = jnp.maximum(n, 1).astype(jnp.float32)
    large = exact + (jnp.log(nf / exact) / math.log(REL_MAX_DIST / exact) * (half - exact)).astype(jnp.int32)
    large = jnp.minimum(large, half - 1)
    return base + jnp.where(n < exact, n, large)


def _dilated_window_attn(q, k, v, dil, rel_bias):
    bt, s, h, hd = q.shape
    L = s // dil
    nb = -(-L // BLK)
    lp = nb * BLK
    n_sub = bt * dil

    def to_sub(t):
        return t.reshape(bt, L, dil, h, hd).transpose(0, 2, 1, 3, 4).reshape(n_sub, L, h, hd)

    def key_blocks(t):
        tp = jnp.pad(t, ((0, 0), (BLK, lp - L + BLK), (0, 0), (0, 0))).reshape(n_sub, nb + 2, BLK, h, hd)
        return jnp.concatenate([tp[:, :-2], tp[:, 1:-1], tp[:, 2:]], axis=2)

    qb = jnp.pad(to_sub(q), ((0, 0), (0, lp - L), (0, 0), (0, 0))).reshape(n_sub, nb, BLK, h, hd)
    kb = key_blocks(to_sub(k))
    vb = key_blocks(to_sub(v))
    logits = jnp.einsum('nbqhd,nbkhd->nbhqk', qb, kb)
    qi = jnp.arange(BLK)[:, None]
    kj = jnp.arange(3 * BLK)[None, :]
    rel = kj - BLK - qi
    bias = rel_bias[_rel_bucket(rel * dil)].astype(jnp.float32).transpose(2, 0, 1)
    key_pos = jnp.arange(nb)[:, None] * BLK + kj - BLK
    allowed = (jnp.abs(rel) <= SIDE_KEYS)[None] & ((key_pos >= 0) & (key_pos < L))[:, None, :]
    logits = jnp.where(allowed[None, :, None], logits + bias[None, None], NEG)
    m = jnp.max(logits, axis=-1, keepdims=True)
    p = jnp.exp(logits - m)
    den = jnp.sum(p, axis=-1)
    den_t = den.transpose(0, 1, 3, 2)
    o = jnp.einsum('nbhqk,nbkhd->nbqhd', p, vb) / den_t[..., None]
    lse = m[..., 0].transpose(0, 1, 3, 2) + jnp.log(den_t)

    def from_sub(t):
        t = t.reshape(bt, dil, lp, *t.shape[3:])[:, :, :L]
        t = jnp.moveaxis(t, 1, 2)
        return t.reshape(bt, s, *t.shape[3:])

    return from_sub(o), from_sub(lse)


def _attention_branch(q, k, v, q_gain, k_gain, rel_bias):
    qf = _head_rms(q, q_gain) * (HEAD_DIM ** -0.5)
    kf = _head_rms(k, k_gain)
    vf = v.astype(jnp.float32)
    outs, lses = [], []
    for _, dil in DILATED_PATTERNS:
        o, l = _dilated_window_attn(qf, kf, vf, dil, rel_bias)
        outs.append(o)
        lses.append(l)
    w = jax.nn.softmax(jnp.stack(lses), axis=0)
    return jnp.einsum('gbsh,gbshd->bshd', w, jnp.stack(outs))


def _cplx_combine(e1, e2):
    a1r, a1i, b1r, b1i = e1
    a2r, a2i, b2r, b2i = e2
    return (a2r * a1r - a2i * a1i,
            a2r * a1i + a2i * a1r,
            a2r * b1r - a2i * b1i + b2r,
            a2r * b1i + a2i * b1r + b2i)


def _s5_scan(u, lam_re, lam_im, log_dt, b_re, b_im, c_re, c_im):
    bt, s, g, hc = u.shape
    dt = jnp.exp(log_dt.astype(jnp.float32))[:, None]
    lr = lam_re.astype(jnp.float32)
    li = lam_im.astype(jnp.float32)
    mag = jnp.exp(lr * dt)
    ab_re = mag * jnp.cos(li * dt)
    ab_im = mag * jnp.sin(li * dt)
    den = lr * lr + li * li
    f_re = ((ab_re - 1.0) * lr + ab_im * li) / den
    f_im = (ab_im * lr - (ab_re - 1.0) * li) / den
    br = b_re.astype(jnp.float32)
    bi = b_im.astype(jnp.float32)
    bb_re = f_re[..., None] * br - f_im[..., None] * bi
    bb_im = f_re[..., None] * bi + f_im[..., None] * br
    cr = c_re.astype(jnp.float32)
    ci = c_im.astype(jnp.float32)
    n_chunks = s // SSM_CHUNK
    uc = u.reshape(bt, n_chunks, SSM_CHUNK, g, hc).transpose(1, 0, 2, 3, 4)

    def chunk(carry, u_c):
        h_re, h_im = carry
        x_re = jnp.einsum('blgh,gph->blgp', u_c, bb_re)
        x_im = jnp.einsum('blgh,gph->blgp', u_c, bb_im)
        a_re = jnp.broadcast_to(ab_re, x_re.shape)
        a_im = jnp.broadcast_to(ab_im, x_im.shape)
        A_re, A_im, X_re, X_im = lax.associative_scan(_cplx_combine, (a_re, a_im, x_re, x_im), axis=1)
        s_re = X_re + A_re * h_re[:, None] - A_im * h_im[:, None]
        s_im = X_im + A_re * h_im[:, None] + A_im * h_re[:, None]
        y = jnp.einsum('blgp,ghp->blgh', s_re, cr) - jnp.einsum('blgp,ghp->blgh', s_im, ci)
        return (s_re[:, -1], s_im[:, -1]), y

    h0 = jnp.zeros((bt, g, SSM_STATE), jnp.float32)
    _, y = lax.scan(chunk, (h0, h0), uc)
    return y.transpose(1, 0, 2, 3, 4).reshape(bt, s, g, hc)


def _layer(x, rel_bias, norm_gain, w_in, q_gain, k_gain, lam_re, lam_im, log_dt,
           b_re, b_im, c_re, c_im, d_skip, w_glu, w_attn_proj, w_ssm_proj, w_out):
    bt, s, _ = x.shape
    h = _rmsnorm(x, norm_gain)
    proj = h @ w_in
    q, k, v, g_a, u, g_b, m_a, m_b = jnp.split(proj, SPLITS, axis=-1)
    shp = (bt, s, N_HEADS, HEAD_DIM)
    o = _attention_branch(q.reshape(shp), k.reshape(shp), v.reshape(shp), q_gain, k_gain, rel_bias)
    o = o.reshape(bt, s, ATTN_WIDTH).astype(x.dtype)
    z_a = (o * jax.nn.silu(g_a)) @ w_attn_proj
    uf = u.astype(jnp.float32)
    ug = uf.reshape(bt, s, SSM_GROUPS, SSM_GROUP)
    y_f = _s5_scan(ug, lam_re[0], lam_im[0], log_dt[0], b_re[0], b_im[0], c_re[0], c_im[0])
    y_b = jnp.flip(_s5_scan(jnp.flip(ug, axis=1), lam_re[1], lam_im[1], log_dt[1],
                            b_re[1], b_im[1], c_re[1], c_im[1]), axis=1)
    y = (y_f + y_b).reshape(bt, s, SSM_WIDTH) + d_skip.astype(jnp.float32) * uf
    y = jax.nn.gelu(y).astype(x.dtype)
    gl = y @ w_glu
    y = gl[..., :SSM_WIDTH] * jax.nn.sigmoid(gl[..., SSM_WIDTH:])
    z_b = (y * jax.nn.silu(g_b)) @ w_ssm_proj
    merged = jax.nn.sigmoid(m_a) * z_a + jax.nn.sigmoid(m_b) * z_b
    return x + merged @ w_out


def setup_inputs(seed: int = 0) -> dict:
    key = jax.random.key(seed)
    ks = jax.random.split(key, 20)
    f32 = jnp.float32
    nrm = lambda kk, shape, sc: jax.random.normal(kk, shape, f32) * sc
    G, P, Hc = SSM_GROUPS, SSM_STATE, SSM_GROUP
    lam_im = jnp.broadcast_to(math.pi * jnp.arange(P, dtype=f32), (DEPTH, 2, G, P)) + nrm(ks[5], (DEPTH, 2, G, P), 0.01)
    log_dt = jax.random.uniform(ks[6], (DEPTH, 2, G), f32, math.log(DT_MIN), math.log(DT_MAX))
    return {
        "x_prompt": nrm(ks[0], (BATCH, SEQ, D_MODEL), 1.0),
        "x_sample": nrm(ks[1], (DEC_BATCH, DEC_SEQ, D_MODEL), 1.0),
        "rel_bias": nrm(ks[2], (N_BUCKETS, N_HEADS), 0.1),
        "norm_gain": 1.0 + nrm(ks[3], (DEPTH, D_MODEL), 0.02),
        "w_in": nrm(ks[4], (DEPTH, D_MODEL, IN_WIDTH), D_MODEL ** -0.5),
        "q_gain": 1.0 + nrm(ks[7], (DEPTH, HEAD_DIM), 0.02),
        "k_gain": 1.0 + nrm(ks[8], (DEPTH, HEAD_DIM), 0.02),
        "lam_re": -0.5 + nrm(ks[9], (DEPTH, 2, G, P), 0.01),
        "lam_im": lam_im,
        "log_dt": log_dt,
        "b_re": nrm(ks[10], (DEPTH, 2, G, P, Hc), (2 * Hc) ** -0.5),
        "b_im": nrm(ks[11], (DEPTH, 2, G, P, Hc), (2 * Hc) ** -0.5),
        "c_re": nrm(ks[12], (DEPTH, 2, G, Hc, P), P ** -0.5),
        "c_im": nrm(ks[13], (DEPTH, 2, G, Hc, P), P ** -0.5),
        "d_skip": nrm(ks[14], (DEPTH, SSM_WIDTH), 1.0),
        "w_glu": nrm(ks[15], (DEPTH, SSM_WIDTH, 2 * SSM_WIDTH), SSM_WIDTH ** -0.5),
        "w_attn_proj": nrm(ks[16], (DEPTH, ATTN_WIDTH, D_MODEL), ATTN_WIDTH ** -0.5),
        "w_ssm_proj": nrm(ks[17], (DEPTH, SSM_WIDTH, D_MODEL), SSM_WIDTH ** -0.5),
        "w_out": nrm(ks[18], (DEPTH, D_MODEL, D_MODEL), D_MODEL ** -0.5),
    }


def reference(x_prompt, x_sample, rel_bias, norm_gain, w_in, q_gain, k_gain, lam_re, lam_im, log_dt,
              b_re, b_im, c_re, c_im, d_skip, w_glu, w_attn_proj, w_ssm_proj, w_out):
    y_prompt = x_prompt
    y_sample = x_sample
    for l in range(DEPTH):
        params = (rel_bias, norm_gain[l], w_in[l], q_gain[l], k_gain[l], lam_re[l], lam_im[l], log_dt[l],
                  b_re[l], b_im[l], c_re[l], c_im[l], d_skip[l], w_glu[l], w_attn_proj[l],
                  w_ssm_proj[l], w_out[l])
        y_prompt = _layer(y_prompt, *params)
        y_sample = _layer(y_sample, *params)
    return (y_prompt, y_sample)
```

```cpp
#include <hip/hip_runtime.h>
#include <hip/hip_cooperative_groups.h>
#include <cstdio>
#include <cstdint>
namespace cg = cooperative_groups;

#ifndef MK_SPLIT
#define MK_SPLIT 0
#endif

#ifndef PROBE_DUP
#define PROBE_DUP 0
#endif
#define LAS __attribute__((address_space(3)))
typedef unsigned short bf16_t;
typedef short bf16x8 __attribute__((ext_vector_type(8)));
typedef short s16x4 __attribute__((ext_vector_type(4)));
typedef float f32x4 __attribute__((ext_vector_type(4)));
typedef float f32x2 __attribute__((ext_vector_type(2)));
typedef unsigned u32x4 __attribute__((ext_vector_type(4)));
typedef unsigned u32x2 __attribute__((ext_vector_type(2)));

constexpr int MTOK = 24576, NPROMPT = 16384, DM = 4096, NIN = 20480, AW = 2048, SW = 2048;
constexpr int NGRP = 128, TCH = 16;
constexpr float EPSN = 1e-6f;
constexpr float LOG2E = 1.4426950408889634f;

constexpr size_t MiB = 1u << 20;
constexpr size_t WS_RINV = 0;
constexpr size_t WS_QKG = 128 * 1024;
constexpr size_t WS_BT = 132 * 1024;
constexpr size_t WS_ATAB = 192 * 1024;
constexpr size_t WS_BAR = 320 * 1024;
constexpr size_t WS_WIN = 1 * MiB;
constexpr size_t WS_WGLU = 161 * MiB;
constexpr size_t WS_WA = 177 * MiB;
constexpr size_t WS_WS = 193 * MiB;
constexpr size_t WS_WO = 209 * MiB;
constexpr size_t WS_SWS = 241 * MiB;
constexpr size_t WS_SWY = 257 * MiB;
constexpr size_t WS_Q = 289 * MiB;
constexpr size_t WS_K = 385 * MiB;
constexpr size_t WS_V = 481 * MiB;
constexpr size_t WS_GA = 577 * MiB;
constexpr size_t WS_UG = 673 * MiB;
constexpr size_t WS_GB = 769 * MiB;
constexpr size_t WS_MA = 865 * MiB;
constexpr size_t WS_MB = 1057 * MiB;
constexpr size_t WS_SSQ = 1249 * MiB;
constexpr size_t WS_END = 1261 * MiB;
constexpr size_t DO_XB = 0, DO_EG = 0, DO_X = 96 * MiB, DO_XD = 160 * MiB, DO_YG = 192 * MiB, DO_HG = 288 * MiB;

constexpr int LDS_BARW = 151552;
constexpr int LDS_BYTES = 151616;

__device__ __forceinline__ unsigned cvt_pk_bf16(float lo, float hi) { unsigned r; asm volatile("v_cvt_pk_bf16_f32 %0, %1, %2" : "=v"(r) : "v"(lo), "v"(hi)); return r; }
__device__ __forceinline__ float bflo(unsigned w) { return __uint_as_float(w << 16); }
__device__ __forceinline__ float bfhi(unsigned w) { return __uint_as_float(w & 0xffff0000u); }
__device__ __forceinline__ float sigm(float v) { return __builtin_amdgcn_rcpf(1.f + __expf(-v)); }
__device__ __forceinline__ float wave_sum(float v) {
#pragma unroll
    for (int o = 1; o < 64; o <<= 1) v += __shfl_xor(v, o);
    return v;
}

namespace pg8 {
constexpr int BM = 256, BK = 64, HALF = 128, HTB = HALF * BK * 2, STAGE_BYTES = 8 * HTB, NXCD = 8, WGM = 8;
__host__ __device__ __forceinline__ int lds_byte(int r, int c) { const int st = (r >> 4) * 2 + (c >> 5), rr = r & 15, cc = c & 31, ob = rr * 64 + cc * 2; return st * 1024 + (ob ^ (((ob >> 9) & 1) << 5)); }
__host__ __device__ __forceinline__ void stage_rc(int b, int& R, int& C) { const int st = b / 1024, sb = b % 1024, swz = sb ^ (((sb >> 9) & 1) << 5); R = (st >> 1) * 16 + swz / 64; C = (st & 1) * 32 + (swz % 64) / 2; }
__host__ __device__ __forceinline__ int perm32(int rho) { const int n = rho >> 4, i = rho & 15; return 8 * (i >> 2) + 4 * n + (i & 3); }

struct Unit { int pm, pn; };
struct Gemm { const bf16_t* A; const bf16_t* Bt; int M, N, K; const bf16_t* A2 = nullptr; int nh = 0, lda = 0; };

struct StaticOrder {
    int nM, nN, nwg, G, c;
    __host__ __device__ void init(int M, int N, int G_, int c_) { nM = M / BM; nN = N / BM; nwg = nM * nN; G = G_; c = c_; }
    __host__ __device__ bool next(int i, Unit& u) const {
        const long L = (long)i * G + c; if (L >= nwg) return false;
        int wgid = (int)L; { const int q = nwg / NXCD, r = nwg % NXCD, xcd = wgid % NXCD, off = wgid / NXCD; wgid = (xcd < r ? xcd * (q + 1) : r * (q + 1) + (xcd - r) * q) + off; }
        const int nig = WGM * nN, gid = wgid / nig, fm = gid * WGM, gsz = (nM - fm) < WGM ? (nM - fm) : WGM;
        u.pm = fm + ((wgid % nig) % gsz); u.pn = (wgid % nig) / gsz; return true;
    }
    __device__ __forceinline__ void a_ready(const Unit&) const {}
    __device__ __forceinline__ void done(const Unit&) const {}
};


struct EpiIn {
    static constexpr bool PERM = true, AFTER_DRAIN = false;
    const float* rinv; const float* qkg; float* ssq;
    bf16_t *Q, *K, *V, *GA, *UG, *GB, *MA, *MB;
    __device__ __forceinline__ void operator()(const f32x4 (&acc)[2][2][4][2], const Unit& u, int wr, int wc, int fr, int fq) const {
        const int colt = u.pn * BM;
        int type, cb, ld, act; bf16_t* base;
        if (colt < 2048)       { type = 0; base = Q;  cb = colt;         ld = 2048; act = 0; }
        else if (colt < 4096)  { type = 1; base = K;  cb = colt - 2048;  ld = 2048; act = 0; }
        else if (colt < 6144)  { type = 2; base = V;  cb = colt - 4096;  ld = 2048; act = 0; }
        else if (colt < 8192)  { type = 3; base = GA; cb = colt - 6144;  ld = 2048; act = 1; }
        else if (colt < 10240) { type = 4; base = UG; cb = colt - 8192;  ld = 2048; act = 0; }
        else if (colt < 12288) { type = 5; base = GB; cb = colt - 10240; ld = 2048; act = 1; }
        else if (colt < 16384) { type = 6; base = MA; cb = colt - 12288; ld = 4096; act = 0; }
        else                   { type = 7; base = MB; cb = colt - 16384; ld = 4096; act = 0; }
        const int row0 = u.pm * BM + wr * 64 + fr;
        const int cw = wc * 32 + 8 * fq;
#pragma unroll
        for (int ai = 0; ai < 2; ++ai)
#pragma unroll
            for (int m = 0; m < 4; ++m) {
                const int row = row0 + ai * HALF + m * 16;

#pragma unroll
                for (int bj = 0; bj < 2; ++bj) {
                    f32x4 v0 = acc[ai][bj][m][0], v1 = acc[ai][bj][m][1];
                    const int col = cb + bj * HALF + cw;
                    if (type <= 1) {
                        float s = (v0[0] * v0[0] + v0[1] * v0[1]) + (v0[2] * v0[2] + v0[3] * v0[3]) + (v1[0] * v1[0] + v1[1] * v1[1]) + (v1[2] * v1[2] + v1[3] * v1[3]);
                        s += __shfl_xor(s, 16); s += __shfl_xor(s, 32);
                        const int hd = type * 16 + (cb >> 7) + bj;
                        if (fq == 0) ssq[(size_t)(hd * 4 + wc) * MTOK + row] = s;
                    }
                    if (type == 0) {
                        const f32x4 g0 = *(const f32x4*)(qkg + (col & 127)), g1 = *(const f32x4*)(qkg + (col & 127) + 4);
                        v0 = v0 * g0; v1 = v1 * g1;
                    }
                    if (act) {
#pragma unroll
                        for (int j = 0; j < 4; ++j) { const float s0 = sigm(v0[j]), s1 = sigm(v1[j]); v0[j] = (act == 1) ? v0[j] * s0 : s0; v1[j] = (act == 1) ? v1[j] * s1 : s1; }
                    }
                    u32x4 w; w.x = cvt_pk_bf16(v0[0], v0[1]); w.y = cvt_pk_bf16(v0[2], v0[3]); w.z = cvt_pk_bf16(v1[0], v1[1]); w.w = cvt_pk_bf16(v1[2], v1[3]);
                    if (type == 4) { const int g = col >> 4, h0 = col & 15; *(u32x4*)(base + ((size_t)g * MTOK + row) * 16 + h0) = w; }
                    else *(u32x4*)(base + (size_t)row * ld + col) = w;
                }
            }
    }
};

template <int MODE> struct EpiEw {
    static constexpr bool PERM = true, AFTER_DRAIN = false;
    bf16_t* P; const bf16_t* Q2; const float* xp; const float* xs; float* out;
    __device__ __forceinline__ void operator()(const f32x4 (&acc)[2][2][4][2], const Unit& u, int wr, int wc, int fr, int fq) const {
        const int row0 = u.pm * BM + wr * 64 + fr;
        const int cw = wc * 32 + 8 * fq;
#pragma unroll
        for (int ai = 0; ai < 2; ++ai)
#pragma unroll
            for (int m = 0; m < 4; ++m) {
                const int row = row0 + ai * HALF + m * 16;
                if (MODE == 0) {
                    bf16_t* p = P + (size_t)row * 2048 + u.pn * HALF + cw;
                    const u32x4 g = *(const u32x4*)p;
                    const f32x4 a0 = acc[ai][0][m][0], a1 = acc[ai][0][m][1], b0 = acc[ai][1][m][0], b1 = acc[ai][1][m][1];
                    float y[8];
#pragma unroll
                    for (int j = 0; j < 4; ++j) { y[j] = a0[j] * sigm(b0[j]); y[4 + j] = a1[j] * sigm(b1[j]); }
                    u32x4 w;
                    w.x = cvt_pk_bf16(y[0] * bflo(g.x), y[1] * bfhi(g.x)); w.y = cvt_pk_bf16(y[2] * bflo(g.y), y[3] * bfhi(g.y));
                    w.z = cvt_pk_bf16(y[4] * bflo(g.z), y[5] * bfhi(g.z)); w.w = cvt_pk_bf16(y[6] * bflo(g.w), y[7] * bfhi(g.w));
                    *(u32x4*)p = w;
                } else {
#pragma unroll
                    for (int bj = 0; bj < 2; ++bj) {
                        const int col = u.pn * BM + bj * HALF + cw;
                        const f32x4 a0 = acc[ai][bj][m][0], a1 = acc[ai][bj][m][1];
                        if (MODE == 1) {
                            bf16_t* p = P + (size_t)row * 4096 + col; const u32x4 g = *(const u32x4*)p; u32x4 w;
                            w.x = cvt_pk_bf16(a0[0] * sigm(bflo(g.x)), a0[1] * sigm(bfhi(g.x))); w.y = cvt_pk_bf16(a0[2] * sigm(bflo(g.y)), a0[3] * sigm(bfhi(g.y)));
                            w.z = cvt_pk_bf16(a1[0] * sigm(bflo(g.z)), a1[1] * sigm(bfhi(g.z))); w.w = cvt_pk_bf16(a1[2] * sigm(bflo(g.w)), a1[3] * sigm(bfhi(g.w)));
                            *(u32x4*)p = w;
                        } else if (MODE == 2) {
                            bf16_t* p = P + (size_t)row * 4096 + col; const u32x4 g = *(const u32x4*)p; const u32x4 q = *(const u32x4*)(Q2 + (size_t)row * 4096 + col); u32x4 w;
                            w.x = cvt_pk_bf16(bflo(g.x) + a0[0] * sigm(bflo(q.x)), bfhi(g.x) + a0[1] * sigm(bfhi(q.x))); w.y = cvt_pk_bf16(bflo(g.y) + a0[2] * sigm(bflo(q.y)), bfhi(g.y) + a0[3] * sigm(bfhi(q.y)));
                            w.z = cvt_pk_bf16(bflo(g.z) + a1[0] * sigm(bflo(q.z)), bfhi(g.z) + a1[1] * sigm(bfhi(q.z))); w.w = cvt_pk_bf16(bflo(g.w) + a1[2] * sigm(bflo(q.w)), bfhi(g.w) + a1[3] * sigm(bfhi(q.w)));
                            *(u32x4*)p = w;
                        } else {
                            const float* xr = (row < NPROMPT) ? xp + (size_t)row * DM + col : xs + (size_t)(row - NPROMPT) * DM + col;
                            const f32x4 x0 = *(const f32x4*)xr, x1 = *(const f32x4*)(xr + 4);
                            float* o = out + (size_t)row * DM + col;
                            *(f32x4*)o = x0 + a0; *(f32x4*)(o + 4) = x1 + a1;
                        }
                    }
                }
            }
    }
};

template <class T, class = void> struct has_mid { static constexpr bool value = false; };
template <class T> struct has_mid<T, decltype((void)T::HAS_MID)> { static constexpr bool value = T::HAS_MID; };
struct EpiMerge {
    static constexpr bool PERM = true, AFTER_DRAIN = false, HAS_MID = true;
    bf16_t* P; const bf16_t* Q2;
    __device__ __forceinline__ void mid(f32x4 (&acc)[2][2][4][2], const Unit& u, int wr, int wc, int fr, int fq) const {
        unsigned zz; asm volatile("s_mov_b32 %0, 0" : "=s"(zz));
        const unsigned row0 = (unsigned)(u.pm * BM + wr * 64 + fr) + zz; const unsigned cw = (unsigned)(u.pn * BM + wc * 32 + 8 * fq);
#pragma unroll
        for (int ai = 0; ai < 2; ++ai)
#pragma unroll
            for (int m = 0; m < 4; ++m)
#pragma unroll
                for (int bj = 0; bj < 2; ++bj) {
                    const unsigned eo = ((row0 + ai * HALF + m * 16) * 4096u + cw + bj * HALF) * 2u;
                    const u32x4 g = *(const u32x4*)((const char*)P + eo), q = *(const u32x4*)((const char*)Q2 + eo);
                    f32x4& a0 = acc[ai][bj][m][0]; f32x4& a1 = acc[ai][bj][m][1];
#define RATIO(ma, mb) (sigm(ma) * (1.f + __expf(-(mb))))
                    a0[0] *= RATIO(bflo(g.x), bflo(q.x)); a0[1] *= RATIO(bfhi(g.x), bfhi(q.x)); a0[2] *= RATIO(bflo(g.y), bflo(q.y)); a0[3] *= RATIO(bfhi(g.y), bfhi(q.y));
                    a1[0] *= RATIO(bflo(g.z), bflo(q.z)); a1[1] *= RATIO(bfhi(g.z), bfhi(q.z)); a1[2] *= RATIO(bflo(g.w), bflo(q.w)); a1[3] *= RATIO(bfhi(g.w), bfhi(q.w));
#undef RATIO
                }
    }
    __device__ __forceinline__ void operator()(const f32x4 (&acc)[2][2][4][2], const Unit& u, int wr, int wc, int fr, int fq) const {
        const unsigned row0 = (unsigned)(u.pm * BM + wr * 64 + fr); const unsigned cw = (unsigned)(u.pn * BM + wc * 32 + 8 * fq);
#pragma unroll
        for (int ai = 0; ai < 2; ++ai)
#pragma unroll
            for (int m = 0; m < 4; ++m)
#pragma unroll
                for (int bj = 0; bj < 2; ++bj) {
                    const unsigned eo = ((row0 + ai * HALF + m * 16) * 4096u + cw + bj * HALF) * 2u;
                    const u32x4 q = *(const u32x4*)((const char*)Q2 + eo);
                    const f32x4 a0 = acc[ai][bj][m][0], a1 = acc[ai][bj][m][1]; u32x4 w;
                    w.x = cvt_pk_bf16(a0[0] * sigm(bflo(q.x)), a0[1] * sigm(bfhi(q.x))); w.y = cvt_pk_bf16(a0[2] * sigm(bflo(q.y)), a0[3] * sigm(bfhi(q.y)));
                    w.z = cvt_pk_bf16(a1[0] * sigm(bflo(q.z)), a1[1] * sigm(bfhi(q.z))); w.w = cvt_pk_bf16(a1[2] * sigm(bflo(q.w)), a1[3] * sigm(bfhi(q.w)));
                    *(u32x4*)((char*)P + eo) = w;
                }
    }
};
struct EpiE {
    static constexpr bool PERM = true, AFTER_DRAIN = false;
    bf16_t* Eg;
    __device__ __forceinline__ void operator()(const f32x4 (&acc)[2][2][4][2], const Unit& u, int wr, int wc, int fr, int fq) const {
        const unsigned row0 = (unsigned)(u.pm * BM + wr * 64 + fr);
#pragma unroll
        for (int ai = 0; ai < 2; ++ai)
#pragma unroll
            for (int m = 0; m < 4; ++m)
#pragma unroll
                for (int bj = 0; bj < 2; ++bj) {
                    const f32x4 a0 = acc[ai][bj][m][0], a1 = acc[ai][bj][m][1];
                    u32x4 w; w.x = cvt_pk_bf16(a0[0], a0[1]); w.y = cvt_pk_bf16(a0[2], a0[3]); w.z = cvt_pk_bf16(a1[0], a1[1]); w.w = cvt_pk_bf16(a1[2], a1[3]);
                    *(u32x4*)((char*)Eg + ((row0 + ai * HALF + m * 16) * 256u + (unsigned)(bj * HALF + wc * 32 + 8 * fq)) * 2u) = w;
                }
    }
};
struct GroupOrder {
    int G, c;
    __device__ __forceinline__ bool next(int i, Unit& u) const {
        int L = i * G + c;
        if (G == 256) { if (i >= 3) return false; L = (c & 7) * 96 + i * 32 + (c >> 3); }
        if (L >= 768) return false; u.pm = L; u.pn = L / 6; return true; }
    __device__ __forceinline__ void a_ready(const Unit&) const {}
    __device__ __forceinline__ void done(const Unit&) const {}
};
struct EpiY {
    static constexpr bool PERM = true, AFTER_DRAIN = false;
    const bf16_t* UG; const float* dskip; bf16_t* YG;
    __device__ __forceinline__ void operator()(const f32x4 (&acc)[2][2][4][2], const Unit& u, int wr, int wc, int fr, int fq) const {
        const int g = u.pn;
        const int crow0 = (u.pm - 6 * g) * BM + wr * 64 + fr;
        const int h0 = 8 * (fq & 1);
#pragma unroll
        for (int ai = 0; ai < 2; ++ai)
#pragma unroll
            for (int m = 0; m < 4; ++m) {
                const int chunk = crow0 + ai * HALF + m * 16;
#pragma unroll
                for (int bj = 0; bj < 2; ++bj) {
                    const int t = 8 * bj + 2 * wc + (fq >> 1);
                    const unsigned tok = (unsigned)chunk * 16u + (unsigned)t;
#pragma unroll
                    for (int nn = 0; nn < 2; ++nn) {
                        const u32x2 uu = *(const u32x2*)((const char*)UG + (((unsigned)g * MTOK + tok) * 16u + (unsigned)(h0 + 4 * nn)) * 2u);
                        const f32x4 d = *(const f32x4*)((const char*)dskip + (unsigned)(g * 16 + h0 + 4 * nn) * 4u);
                        const f32x4 a = acc[ai][bj][m][nn];
                        float y[4];
                        y[0] = a[0] + d[0] * bflo(uu.x); y[1] = a[1] + d[1] * bfhi(uu.x); y[2] = a[2] + d[2] * bflo(uu.y); y[3] = a[3] + d[3] * bfhi(uu.y);
#pragma unroll
                        for (int j = 0; j < 4; ++j) { const float z = 0.7978845608028654f * (y[j] + 0.044715f * y[j] * y[j] * y[j]); y[j] = y[j] * sigm(2.0f * z); }
                        u32x2 w; w.x = cvt_pk_bf16(y[0], y[1]); w.y = cvt_pk_bf16(y[2], y[3]);
                        *(u32x2*)((char*)YG + (((unsigned)g * MTOK + tok) * 16u + (unsigned)(h0 + 4 * nn)) * 2u) = w;
                    }
                }
            }
    }
};
template <class Epi, class Sched, bool ALIGN_EPI = false, bool SP2 = false, bool TWOA = false, bool AGM = false>
__device__ __forceinline__ void gemm_phase(LAS unsigned char* lds, const Gemm g, const Sched& S, const Epi& E, int wid) {
    unsigned z_; asm volatile("s_mov_b32 %0, 0" : "=s"(z_));
    const int lane_ = (int)__builtin_amdgcn_mbcnt_hi(~0u, __builtin_amdgcn_mbcnt_lo(~0u, z_));
    const int lane = lane_, tid = wid * 64 + lane, wr = wid >> 2, wc = wid & 3, fr = lane & 15, fq = lane >> 4;
    const int K = g.K, nt = K / BK;
    const int lda = TWOA ? g.lda : K, nh = TWOA ? g.nh : nt;
    unsigned voffA[2], voffB[2];
#pragma unroll
    for (int i = 0; i < 2; ++i) { int R, C; stage_rc(tid * 16 + i * 8192, R, C); const int Rb = Epi::PERM ? ((R & ~31) + perm32(R & 31)) : R;
        voffA[i] = AGM ? (unsigned)((C >> 4) * (MTOK * 16) + R * 16 + (C & 15)) * 2u : (unsigned)(R * lda + C) * 2u; voffB[i] = (unsigned)(Rb * K + C) * 2u; }
    const size_t kstep = (size_t)(BK * 2);
    const size_t hstep = (size_t)HALF * K * 2;
    const size_t tstep = 2 * hstep;
    const size_t hstepA = AGM ? (size_t)HALF * 32 : (size_t)HALF * lda * 2, tstepA = 2 * hstepA, kstepA = AGM ? (size_t)4 * MTOK * 32 : kstep;
    const unsigned ldsw = (unsigned)wid * 1024u;
    const int aoff = lds_byte(wr * 64 + fr, fq * 8), boff = lds_byte(wc * 32 + fr, fq * 8);
#define PG8_SA(b, h) (((b) * 2 + (h)) * HTB)
#define PG8_SB(b, h) ((4 + (b) * 2 + (h)) * HTB)
#define PG8_STAGE(bufoff, gbase, voff) do { _Pragma("unroll") for (int _i = 0; _i < 2; ++_i) \
        __builtin_amdgcn_global_load_lds((const unsigned*)((const char*)(gbase) + (voff)[_i]), (LAS unsigned*)(lds + (bufoff) + ldsw + _i * 8192), 16, 0, 0); } while (0)
#define PG8_LDA(dst, b, h) do { _Pragma("unroll") for (int m = 0; m < 4; ++m) _Pragma("unroll") for (int k = 0; k < 2; ++k) dst[m][k] = *(const LAS bf16x8*)(lds + PG8_SA(b, h) + aoff + m * 2048 + k * 1024); } while (0)
#define PG8_LDB(dst, b, h) do { _Pragma("unroll") for (int n = 0; n < 2; ++n) _Pragma("unroll") for (int k = 0; k < 2; ++k) dst[n][k] = *(const LAS bf16x8*)(lds + PG8_SB(b, h) + boff + n * 2048 + k * 1024); } while (0)
#define PG8_MMA(ai, bj, At, Bt) do { __builtin_amdgcn_s_setprio(1); _Pragma("unroll") for (int m = 0; m < 4; ++m) _Pragma("unroll") for (int n = 0; n < 2; ++n) _Pragma("unroll") for (int k = 0; k < 2; ++k) \
        acc[ai][bj][m][n] = __builtin_amdgcn_mfma_f32_16x16x32_bf16(Bt[n][k], At[m][k], acc[ai][bj][m][n], 0, 0, 0); __builtin_amdgcn_s_setprio(0); } while (0)
#define PG8_WAIT_V(n) asm volatile("s_waitcnt vmcnt(" #n ")" ::: "memory")
#define PG8_WAIT_L(n) asm volatile("s_waitcnt lgkmcnt(" #n ")" ::: "memory")
#define PG8_BAR __builtin_amdgcn_s_barrier()
#define PG8_SCHED __builtin_amdgcn_sched_barrier(0)
    Unit cur, nxt; int ui = 0;
    if (!S.next(0, cur)) return;
    f32x4 acc[2][2][4][2];
#pragma unroll
    for (int a = 0; a < 2; ++a)
#pragma unroll
        for (int b = 0; b < 2; ++b)
#pragma unroll
            for (int m = 0; m < 4; ++m)
#pragma unroll
                for (int n = 0; n < 2; ++n) acc[a][b][m][n] = (f32x4){0.f, 0.f, 0.f, 0.f};
    bf16x8 At[4][2], B0[2][2], B1[2][2];
    const char* cA = (const char*)g.A + (size_t)cur.pm * tstepA; const char* cB = (const char*)g.Bt + (size_t)cur.pn * tstep;
    S.a_ready(cur);
    if constexpr (SP2) {
        PG8_STAGE(PG8_SB(0, 0), cB, voffB); PG8_STAGE(PG8_SB(0, 1), cB + hstep, voffB); PG8_STAGE(PG8_SA(0, 0), cA, voffA); PG8_STAGE(PG8_SA(0, 1), cA + hstepA, voffA);
        if (wr == 1) PG8_BAR;
        PG8_WAIT_V(2); PG8_BAR;
        PG8_STAGE(PG8_SB(1, 0), cB + kstep, voffB); PG8_STAGE(PG8_SA(1, 0), cA + kstepA, voffA); PG8_STAGE(PG8_SB(1, 1), cB + hstep + kstep, voffB);
        PG8_WAIT_V(6); PG8_BAR;
    } else {
        PG8_STAGE(PG8_SB(0, 0), cB, voffB); PG8_STAGE(PG8_SA(0, 0), cA, voffA); PG8_STAGE(PG8_SB(0, 1), cB + hstep, voffB); PG8_STAGE(PG8_SA(0, 1), cA + hstepA, voffA);
        if (wr == 1) PG8_BAR;
        PG8_WAIT_V(4); PG8_BAR;
        PG8_STAGE(PG8_SB(1, 0), cB + kstep, voffB); PG8_STAGE(PG8_SA(1, 0), cA + kstepA, voffA); PG8_STAGE(PG8_SB(1, 1), cB + hstep + kstep, voffB);
        PG8_WAIT_V(6); PG8_BAR;
    }
    for (;;) {
        const bool has_next = S.next(ui + 1, nxt);
        const char* nA = has_next ? (const char*)g.A + (size_t)nxt.pm * tstepA : cA; const char* nB = has_next ? (const char*)g.Bt + (size_t)nxt.pn * tstep : cB;
        for (int t = 0; t < nt; t += 2) {
            const bool last = (t == nt - 2);
            const char* cA2 = TWOA ? (const char*)g.A2 + (cA - (const char*)g.A) - (size_t)nh * kstepA : cA;
            const char* a1_ = (TWOA && t + 1 >= nh ? cA2 : cA) + (size_t)(t + 1) * kstepA;
            const char* a2_ = last ? nA : (TWOA && t + 2 >= nh ? cA2 : cA) + (size_t)(t + 2) * kstepA; const char* a1 = a1_; const char* a2 = a2_; const char* b2 = last ? nB : cB + (size_t)(t + 2) * kstep;
            if constexpr (TWOA) { asm volatile("" : "+s"(a1)); asm volatile("" : "+s"(a2)); }
            const char* a3 = a2 + kstepA; const char* b3 = b2 + kstep;
            if (last && has_next) S.a_ready(nxt);
            if constexpr (has_mid<Epi>::value) { if (t == nh) E.mid(acc, cur, wr, wc, fr, fq); }
            if constexpr (SP2) {
            PG8_LDB(B0, 0, 0); PG8_LDB(B1, 0, 1); PG8_SCHED; PG8_LDA(At, 0, 0); PG8_STAGE(PG8_SA(1, 1), a1 + hstepA, voffA);
            PG8_WAIT_V(8); PG8_WAIT_L(0); PG8_BAR; PG8_MMA(0, 0, At, B0); PG8_MMA(0, 1, At, B1); PG8_BAR; PG8_SCHED;
            PG8_LDA(At, 0, 1); PG8_STAGE(PG8_SB(0, 0), b2, voffB); PG8_STAGE(PG8_SB(0, 1), b2 + hstep, voffB); PG8_STAGE(PG8_SA(0, 0), a2, voffA);
            PG8_WAIT_V(8); PG8_WAIT_L(0); PG8_BAR; PG8_MMA(1, 0, At, B0); PG8_MMA(1, 1, At, B1); PG8_BAR; PG8_SCHED;
            PG8_LDB(B0, 1, 0); PG8_LDB(B1, 1, 1); PG8_SCHED; PG8_LDA(At, 1, 0); PG8_STAGE(PG8_SA(0, 1), a2 + hstepA, voffA);
            PG8_WAIT_V(8); PG8_WAIT_L(0); PG8_BAR; PG8_MMA(0, 0, At, B0); PG8_MMA(0, 1, At, B1); PG8_BAR; PG8_SCHED;
            PG8_LDA(At, 1, 1); PG8_STAGE(PG8_SB(1, 0), b3, voffB); PG8_STAGE(PG8_SB(1, 1), b3 + hstep, voffB); PG8_STAGE(PG8_SA(1, 0), a3, voffA);
            PG8_WAIT_V(8); PG8_WAIT_L(0); PG8_BAR; PG8_MMA(1, 0, At, B0); PG8_MMA(1, 1, At, B1); PG8_BAR; PG8_SCHED;
            } else {
            PG8_LDB(B0, 0, 0); PG8_SCHED; PG8_LDA(At, 0, 0); PG8_STAGE(PG8_SA(1, 1), a1 + hstepA, voffA);
            PG8_WAIT_L(8); PG8_BAR; PG8_WAIT_L(0); PG8_MMA(0, 0, At, B0); PG8_BAR; PG8_SCHED;
            PG8_LDB(B1, 0, 1); PG8_STAGE(PG8_SB(0, 0), b2, voffB);
            PG8_BAR; PG8_WAIT_L(0); PG8_MMA(0, 1, At, B1); PG8_BAR;
            PG8_LDA(At, 0, 1); PG8_STAGE(PG8_SA(0, 0), a2, voffA);
            PG8_BAR; PG8_WAIT_L(0); PG8_MMA(1, 0, At, B0); PG8_BAR; PG8_SCHED;
            PG8_STAGE(PG8_SB(0, 1), b2 + hstep, voffB);
            PG8_WAIT_V(6); PG8_BAR; PG8_MMA(1, 1, At, B1); PG8_BAR;
            PG8_LDB(B0, 1, 0); PG8_SCHED; PG8_LDA(At, 1, 0); PG8_STAGE(PG8_SA(0, 1), a2 + hstepA, voffA);
            PG8_WAIT_L(8); PG8_BAR; PG8_WAIT_L(0); PG8_MMA(0, 0, At, B0); PG8_BAR; PG8_SCHED;
            PG8_LDB(B1, 1, 1); PG8_STAGE(PG8_SB(1, 0), b3, voffB);
            PG8_BAR; PG8_WAIT_L(0); PG8_MMA(0, 1, At, B1); PG8_BAR;
            PG8_LDA(At, 1, 1); PG8_STAGE(PG8_SA(1, 0), a3, voffA);
            PG8_BAR; PG8_WAIT_L(0); PG8_MMA(1, 0, At, B0); PG8_BAR; PG8_SCHED;
            PG8_STAGE(PG8_SB(1, 1), b3 + hstep, voffB);
            PG8_WAIT_V(6); PG8_BAR; PG8_MMA(1, 1, At, B1); PG8_BAR;
            }
        }
        if constexpr (ALIGN_EPI) { if (wr == 0) PG8_BAR; }
        if constexpr (!Epi::AFTER_DRAIN) { E(acc, cur, wr, wc, fr, fq); S.done(cur); }
        if (!has_next) break;
#pragma unroll
        for (int a = 0; a < 2; ++a)
#pragma unroll
            for (int b = 0; b < 2; ++b)
#pragma unroll
                for (int m = 0; m < 4; ++m)
#pragma unroll
                    for (int n = 0; n < 2; ++n) acc[a][b][m][n] = (f32x4){0.f, 0.f, 0.f, 0.f};
        cur = nxt; cA = nA; cB = nB; ++ui;
        if constexpr (ALIGN_EPI) { if (wr == 1) PG8_BAR; }
    }
    PG8_WAIT_V(0);
    if constexpr (!ALIGN_EPI) { if (wr == 0) PG8_BAR; }
    PG8_BAR;
#undef PG8_SA
#undef PG8_SB
#undef PG8_STAGE
#undef PG8_LDA
#undef PG8_LDB
#undef PG8_MMA
#undef PG8_WAIT_V
#undef PG8_WAIT_L
#undef PG8_BAR
#undef PG8_SCHED
}
}

struct Args {
    const float* in[19];
    float* out; unsigned char* ws;
    int ph_lo, ph_hi;
};

template <int MODE>
__device__ __forceinline__ void p0_transpose_item(const float* W, int K, int N, bf16_t* WT, const float* gain, LAS float* scr, int item, int lane, int ldw, int koff) {
    const int nblk = N / 32, kb = item / nblk, nb = item % nblk, k0 = 64 * kb, n0 = 32 * nb;
    float tv[32];
#pragma unroll
    for (int i = 0; i < 32; ++i) { const int kk = 2 * i + (lane >> 5); tv[i] = W[(size_t)(k0 + kk) * N + n0 + (lane & 31)]; }
#pragma unroll
    for (int i = 0; i < 32; ++i) { const int kk = 2 * i + (lane >> 5); float v = tv[i]; if (MODE == 1) v *= gain[k0 + kk]; scr[kk * 33 + (lane & 31)] = v; }
    asm volatile("s_waitcnt lgkmcnt(0)" ::: "memory");
    const int c = lane & 7;
#pragma unroll
    for (int j = 0; j < 4; ++j) { const int n = (lane >> 3) + 8 * j; const LAS float* s = scr + (8 * c) * 33 + n;
        u32x4 o; o.x = cvt_pk_bf16(s[0 * 33], s[1 * 33]); o.y = cvt_pk_bf16(s[2 * 33], s[3 * 33]); o.z = cvt_pk_bf16(s[4 * 33], s[5 * 33]); o.w = cvt_pk_bf16(s[6 * 33], s[7 * 33]);
        int nn = n0 + n;
        if (MODE == 2) { const int half = nn >> 11, r = nn & 2047; nn = ((r >> 7) << 8) + (half << 7) + (r & 127); }
        *(u32x4*)(WT + (size_t)nn * ldw + koff + k0 + 8 * c) = o; }
    asm volatile("s_waitcnt lgkmcnt(0)" ::: "memory");
}

__device__ __forceinline__ int rel_bucket(int rel) {
    const int n = rel < 0 ? -rel : rel; const int base = rel > 0 ? 16 : 0;
    const float nf = (float)(n > 1 ? n : 1);
    int large = 8 + (int)((logf(nf / 8.0f) / 4.852030263919617f) * 8.0f);
    large = large < 15 ? large : 15;
    return base + (n < 8 ? n : large);
}

__device__ __forceinline__ void p0_ssm_group(const Args& a, LAS unsigned char* lds, int g, int tid) {
    LAS float* AP = (LAS float*)lds;
    LAS float* FF = AP + 2 * 64 * 17 * 2;
    LAS float* BBm = FF + 2 * 64 * 2;
    LAS float* CC = BBm + 2 * 64 * 16 * 2;
    LAS float* KD = CC + 2 * 16 * 64 * 2;
    const float *lam_re = a.in[7], *lam_im = a.in[8], *log_dt = a.in[9], *b_re = a.in[10], *b_im = a.in[11], *c_re = a.in[12], *c_im = a.in[13];
    float* atab = (float*)(a.ws + WS_ATAB);
    if (tid < 128) {
        const int d = tid >> 6, p = tid & 63;
        const float dt = expf(log_dt[d * NGRP + g]);
        const float lr = lam_re[(d * NGRP + g) * 64 + p], li = lam_im[(d * NGRP + g) * 64 + p];
        const float lrd = lr * dt, lid = li * dt;
        for (int e = 0; e <= 16; ++e) {
            const float mg = expf((float)e * lrd); float sn, cs; sincosf((float)e * lid, &sn, &cs);
            AP[((d * 64 + p) * 17 + e) * 2 + 0] = mg * cs; AP[((d * 64 + p) * 17 + e) * 2 + 1] = mg * sn;
            if (e == 16) { atab[((g * 2 + d) * 64 + p) * 2 + 0] = mg * cs; atab[((g * 2 + d) * 64 + p) * 2 + 1] = mg * sn; }
        }
        const float mg = expf(lrd); float sn, cs; sincosf(lid, &sn, &cs);
        const float abr = mg * cs, abi = mg * sn, den = lr * lr + li * li;
        FF[(d * 64 + p) * 2 + 0] = ((abr - 1.0f) * lr + abi * li) / den;
        FF[(d * 64 + p) * 2 + 1] = (abi * lr - (abr - 1.0f) * li) / den;
    }
    __syncthreads();
    for (int i = tid; i < 2048; i += 512) {
        const int d = i >> 10, p = (i >> 4) & 63, h = i & 15;
        const float fr_ = FF[(d * 64 + p) * 2], fi_ = FF[(d * 64 + p) * 2 + 1];
        const float br = b_re[((size_t)(d * NGRP + g) * 64 + p) * 16 + h], bi = b_im[((size_t)(d * NGRP + g) * 64 + p) * 16 + h];
        BBm[i * 2 + 0] = fr_ * br - fi_ * bi; BBm[i * 2 + 1] = fr_ * bi + fi_ * br;
        const int h2 = (i >> 6) & 15, p2 = i & 63;
        CC[i * 2 + 0] = c_re[((size_t)(d * NGRP + g) * 16 + h2) * 64 + p2]; CC[i * 2 + 1] = c_im[((size_t)(d * NGRP + g) * 16 + h2) * 64 + p2];
    }
    __syncthreads();
    for (int i = tid; i < 8192; i += 512) {
        const int d = i >> 12, tau = (i >> 8) & 15, h = (i >> 4) & 15, hp = i & 15;
        float s = 0.f;
        for (int p = 0; p < 64; ++p) {
            const float ar = AP[((d * 64 + p) * 17 + tau) * 2], ai = AP[((d * 64 + p) * 17 + tau) * 2 + 1];
            const float br = BBm[((d * 64 + p) * 16 + hp) * 2], bi = BBm[((d * 64 + p) * 16 + hp) * 2 + 1];
            const float wr_ = ar * br - ai * bi, wi_ = ar * bi + ai * br;
            const float cr = CC[((d * 16 + h) * 64 + p) * 2], ci = CC[((d * 16 + h) * 64 + p) * 2 + 1];
            s += cr * wr_ - ci * wi_;
        }
        KD[i] = s;
    }
    __syncthreads();
    bf16_t* WsT = (bf16_t*)(a.ws + WS_SWS) + (size_t)g * 256 * 256;
    bf16_t* Wy = (bf16_t*)(a.ws + WS_SWY) + (size_t)g * 256 * 512;
    for (int i = tid; i < 256 * 32; i += 512) {
        const int n = i >> 5, k0 = (i & 31) * 8;
        const int d = n >> 7, ri = (n >> 6) & 1, p = n & 63;
        float v[8];
#pragma unroll
        for (int q = 0; q < 8; ++q) { const int k = k0 + q, j = k >> 4, h = k & 15; const int e = d == 0 ? 15 - j : j;
            const float ar = AP[((d * 64 + p) * 17 + e) * 2], ai = AP[((d * 64 + p) * 17 + e) * 2 + 1];
            const float br = BBm[((d * 64 + p) * 16 + h) * 2], bi = BBm[((d * 64 + p) * 16 + h) * 2 + 1];
            v[q] = ri == 0 ? ar * br - ai * bi : ar * bi + ai * br; }
        u32x4 o; o.x = cvt_pk_bf16(v[0], v[1]); o.y = cvt_pk_bf16(v[2], v[3]); o.z = cvt_pk_bf16(v[4], v[5]); o.w = cvt_pk_bf16(v[6], v[7]);
        *(u32x4*)(WsT + (size_t)n * 256 + k0) = o;
    }
    for (int i = tid; i < 256 * 64; i += 512) {
        const int n = i >> 6, k0 = (i & 63) * 8;
        const int t = n >> 4, h = n & 15;
        float v[8];
#pragma unroll
        for (int q = 0; q < 8; ++q) { const int k = k0 + q;
            if (k < 256) { const int j = k >> 4, hp = k & 15; float s = 0.f;
                if (j <= t) s += KD[((0 * 16 + (t - j)) * 16 + h) * 16 + hp];
                if (j >= t) s += KD[((1 * 16 + (j - t)) * 16 + h) * 16 + hp];
                v[q] = s;
            } else { const int nn = k - 256, d = nn >> 7, ri = (nn >> 6) & 1, p = nn & 63; const int e = d == 0 ? t + 1 : 16 - t;
                const float ar = AP[((d * 64 + p) * 17 + e) * 2], ai = AP[((d * 64 + p) * 17 + e) * 2 + 1];
                const float cr = CC[((d * 16 + h) * 64 + p) * 2], ci = CC[((d * 16 + h) * 64 + p) * 2 + 1];
                v[q] = ri == 0 ? (cr * ar - ci * ai) : -(cr * ai + ci * ar); }
        }
        u32x4 o; o.x = cvt_pk_bf16(v[0], v[1]); o.y = cvt_pk_bf16(v[2], v[3]); o.z = cvt_pk_bf16(v[4], v[5]); o.w = cvt_pk_bf16(v[6], v[7]);
        *(u32x4*)(Wy + (size_t)n * 512 + k0) = o;
    }
    __syncthreads();
}

__device__ __forceinline__ void p0_prologue(const Args& a, LAS unsigned char* lds, int tid, int lane, int wave) {
    const int G = gridDim.x, bx = blockIdx.x;
    for (int g = bx; g < NGRP; g += G) p0_ssm_group(a, lds, g, tid);
    if (bx == G - 1) {
        const float *qg = a.in[5], *kg = a.in[6], *rb = a.in[2];
        float gmax = 0.f, bmax = 0.f;
        for (int d = 0; d < 128; ++d) gmax = fmaxf(gmax, fabsf(qg[d] * kg[d]));
        for (int i = 0; i < 512; ++i) bmax = fmaxf(bmax, fabsf(rb[i]));
        const float shift = 11.313708499f * gmax + bmax + 0.5f;
        float* qkg = (float*)(a.ws + WS_QKG); float* bt = (float*)(a.ws + WS_BT);
        if (tid < 128) qkg[tid] = qg[tid] * kg[tid] * 0.08838834764831845f;
        for (int i = tid; i < 16 * 3 * 192; i += 512) {
            const int h = i / 576, r = i % 576, pi = r / 192, idx = r % 192 - 32; const int dil = pi == 0 ? 1 : (pi == 1 ? 4 : 16);
            bt[i] = (idx < 0 || idx > 128) ? -1e30f : (rb[rel_bucket((idx - 64) * dil) * 16 + h] - shift) * LOG2E;
        }
    }
    __syncthreads();
    LAS float* scr = (LAS float*)(lds + wave * 16384);
    const int gw = bx * 8 + wave, NGW = G * 8;
    bf16_t* W_in = (bf16_t*)(a.ws + WS_WIN); bf16_t* W_glu = (bf16_t*)(a.ws + WS_WGLU); bf16_t* W_a = (bf16_t*)(a.ws + WS_WA); bf16_t* W_s = (bf16_t*)(a.ws + WS_WS); bf16_t* W_o = (bf16_t*)(a.ws + WS_WO);
    constexpr int I_IN = (DM / 64) * (NIN / 32), I_GLU = (SW / 64) * (4096 / 32), I_A = (AW / 64) * (DM / 32), I_S = I_A, I_O = (DM / 64) * (DM / 32);
    constexpr int NITEMS = I_IN + I_GLU + I_A + I_S + I_O;
    bf16_t* XB = (bf16_t*)((unsigned char*)a.out + DO_XB); float* rinv = (float*)(a.ws + WS_RINV);
    const bool uneven = (G == 2 * NGRP);
    const bool lowb = bx < NGRP;
    const int cw = uneven ? (lowb ? bx : bx - NGRP) * 8 + wave : gw, ncw = uneven ? NGRP * 8 : NGW;
    const int csh = uneven ? (lowb ? 9 : 11) : 20, cof = uneven ? (lowb ? 0 : 9) : 0;
    for (int j = cw; ; j += ncw) {
        const int it = (j / csh) * 20 + cof + (j % csh);
        if (it >= NITEMS + MTOK) break;
        if (it < NITEMS) {
            int r = it;
            if (r < I_IN) { p0_transpose_item<1>(a.in[4], DM, NIN, W_in, a.in[3], scr, r, lane, DM, 0); continue; } r -= I_IN;
            if (r < I_GLU) { p0_transpose_item<2>(a.in[15], SW, 4096, W_glu, nullptr, scr, r, lane, SW, 0); continue; } r -= I_GLU;
            if (r < I_A) { p0_transpose_item<0>(a.in[16], AW, DM, W_a, nullptr, scr, r, lane, 4096, 0); continue; } r -= I_A;
            if (r < I_S) { p0_transpose_item<0>(a.in[17], SW, DM, W_a, nullptr, scr, r, lane, 4096, 2048); continue; } r -= I_S;
            p0_transpose_item<0>(a.in[18], DM, DM, W_o, nullptr, scr, r, lane, DM, 0);
            continue;
        }
        const int m = it - NITEMS;
        const float* xrow = (m < NPROMPT) ? a.in[0] + (size_t)m * DM : a.in[1] + (size_t)(m - NPROMPT) * DM;
        const f32x4* xr = (const f32x4*)xrow + lane;
        unsigned long long* o8 = (unsigned long long*)(XB + (size_t)m * DM) + lane;
        float s = 0.f; f32x4 xv[16];
#pragma unroll
        for (int jj = 0; jj < 16; ++jj) { xv[jj] = xr[64 * jj]; s += (xv[jj].x * xv[jj].x + xv[jj].y * xv[jj].y) + (xv[jj].z * xv[jj].z + xv[jj].w * xv[jj].w); }
        s = wave_sum(s);
        const float ri = 1.0f / sqrtf(s * (1.0f / DM) + EPSN);
#pragma unroll
        for (int jj = 0; jj < 16; ++jj) o8[64 * jj] = (unsigned long long)cvt_pk_bf16(xv[jj].x * ri, xv[jj].y * ri) | ((unsigned long long)cvt_pk_bf16(xv[jj].z * ri, xv[jj].w * ri) << 32);
    }
}

__device__ __forceinline__ void ssm_scan(const Args& a, int sc, int lane) {
    const int g = sc >> 3, sidx = (sc >> 1) & 3, d = sc & 1, p = lane;
    const int seq_start = sidx < 2 ? sidx * 8192 : 16384 + (sidx - 2) * 4096, S = sidx < 2 ? 8192 : 4096, nC = S / TCH;
    const bf16_t* E = (const bf16_t*)((unsigned char*)a.out + DO_EG) + ((size_t)g * 1536 + (seq_start >> 4)) * 256;
    bf16_t* H = (bf16_t*)((unsigned char*)a.out + DO_HG) + ((size_t)g * 1536 + (seq_start >> 4)) * 256;
    const float* atab = (const float*)(a.ws + WS_ATAB);
    const float ar = atab[((g * 2 + d) * 64 + p) * 2], ai = atab[((g * 2 + d) * 64 + p) * 2 + 1];
    float hr = 0.f, hi = 0.f;
    const int nb = d * 128 + p;
    float er[16], ei[16], nr_[16], ni_[16];
#pragma unroll
    for (int q = 0; q < 16; ++q) { const int c = d == 0 ? q : nC - 1 - q; er[q] = __uint_as_float((unsigned)E[(size_t)c * 256 + nb] << 16); ei[q] = __uint_as_float((unsigned)E[(size_t)c * 256 + nb + 64] << 16); }
    for (int cb = 0; cb < nC; cb += 16) {
        const int cn = cb + 16 < nC ? cb + 16 : cb;
#pragma unroll
        for (int q = 0; q < 16; ++q) { const int c = d == 0 ? cn + q : nC - 1 - (cn + q); nr_[q] = __uint_as_float((unsigned)E[(size_t)c * 256 + nb] << 16); ni_[q] = __uint_as_float((unsigned)E[(size_t)c * 256 + nb + 64] << 16); }
#pragma unroll
        for (int q = 0; q < 16; ++q) { const int c = d == 0 ? cb + q : nC - 1 - (cb + q);
            H[(size_t)c * 256 + nb] = (bf16_t)(cvt_pk_bf16(hr, 0.f) & 0xffffu); H[(size_t)c * 256 + nb + 64] = (bf16_t)(cvt_pk_bf16(hi, 0.f) & 0xffffu);
            const float nr = ar * hr - ai * hi + er[q], ni = ar * hi + ai * hr + ei[q]; hr = nr; hi = ni; }
#pragma unroll
        for (int q = 0; q < 16; ++q) { er[q] = nr_[q]; ei[q] = ni_[q]; }
    }
}

__device__ __forceinline__ unsigned off_b(unsigned row, unsigned ch) { return 256u * row + 16u * (ch ^ (((row & 3) << 2) | ((row >> 2) & 3))); }
__device__ __forceinline__ unsigned off_a(unsigned row, unsigned ch) { return 2048u * (row >> 3) + 512u * (ch >> 2) + 64u * (row & 7) + 16u * ((ch & 3) ^ ((row >> 2) & 3)); }

template <bool DRY>
__device__ __forceinline__ void attn_unit(const Args& a, LAS unsigned char* lds, int cidx, int h, int lane, int wave) {
    const int tok0 = cidx * 512;
    const int seq_start = tok0 < NPROMPT ? (tok0 & ~8191) : NPROMPT + ((tok0 - NPROMPT) & ~4095);
    const int S = tok0 < NPROMPT ? 8192 : 4096, Pu = tok0 - seq_start;
    const bf16_t* Qb = (const bf16_t*)(a.ws + WS_Q); const bf16_t* Kb = (const bf16_t*)(a.ws + WS_K); const bf16_t* Vb = (const bf16_t*)(a.ws + WS_V);
    bf16_t* GA = (bf16_t*)(a.ws + WS_GA); const float* ssq = (const float*)(a.ws + WS_SSQ);
    float* X = (float*)((unsigned char*)a.out + DO_X + (size_t)blockIdx.x * 262144);
    float* Xd = (float*)((unsigned char*)a.out + DO_XD + (size_t)blockIdx.x * 4096);
    LAS unsigned char* wl = lds + wave * 18944;
    LAS unsigned char* kt = wl; LAS unsigned char* vt = wl + 8192; LAS float* rkb = (LAS float*)(wl + 16384); LAS float* kng = (LAS float*)(wl + 16384 + 128); LAS float* btw = (LAS float*)(wl + 16384 + 256);
    const int fr = lane & 15, fq = lane >> 4;
    {
#pragma unroll
        for (int i = 0; i < 9; ++i) btw[lane + 64 * i] = *(const float*)((const char*)a.ws + WS_BT + (unsigned)(h * 576 + lane + 64 * i) * 4u);
    }
    const int ch = lane & 15, r0 = lane >> 4;
    const unsigned q4 = (lane & 15) >> 2, p4 = lane & 3;
    const unsigned kbase = off_a(fr, fq);
    const unsigned tb0 = off_a(8 * fq + q4, (p4 >> 1)) + 8 * (p4 & 1);
    const unsigned wb0 = 512u * (ch >> 2) + 64u * r0 + 16u * (ch & 3);
#define TB(ce, t) ((tb0 ^ (32u * (ce) + 16u * (t))) + 256u * (t))
#define WB(x) (wb0 ^ (16u * (x)))
#pragma unroll 1
    for (int pass = 0; pass < 6; ++pass) {
        const int pi = pass >> 1, pr = wave + 8 * (pass & 1);
        const int dsh = 2 * pi, res = pr >> (4 - dsh), sub = pr & ((16 >> dsh) - 1), L = S >> dsh;
        const int sq0 = (Pu >> dsh) + 32 * sub, start = sq0 - 64;
        const LAS float* btp = btw + pi * 192;
        bf16x8 qf[2][4]; float rq[2]; int qpos[2];
#pragma unroll
        for (int gq = 0; gq < 2; ++gq) {
            qpos[gq] = res + ((sq0 + 16 * gq + fr) << dsh);
            const unsigned qtok = (unsigned)(seq_start + qpos[gq]);
            const unsigned qoff = (qtok * AW + h * 128 + fq * 8) * 2u;
#pragma unroll
            for (int s = 0; s < 4; ++s) qf[gq][s] = *(const bf16x8*)((const char*)Qb + qoff + s * 64);
            rq[gq] = *(const float*)((const char*)ssq + ((unsigned)(h * 4) * MTOK + qtok) * 4u);
        }
        f32x4 o[2][8];
#pragma unroll
        for (int gq = 0; gq < 2; ++gq)
#pragma unroll
            for (int c = 0; c < 8; ++c) o[gq][c] = (f32x4){0.f, 0.f, 0.f, 0.f};
        float den[2] = {0.f, 0.f};
        u32x4 kreg[8], vreg[8]; float rks;
#define ATT_LOAD(step) do { \
            _Pragma("unroll") for (int i = 0; i < 8; ++i) { const int ks_ = start + 32 * (step) + r0 + 4 * i; const int kc_ = ks_ < 0 ? 0 : (ks_ >= L ? L - 1 : ks_); \
                const unsigned off_ = ((unsigned)(seq_start + res + (kc_ << dsh)) * AW + h * 128 + ch * 8) * 2u; kreg[i] = *(const u32x4*)((const char*)Kb + off_); vreg[i] = *(const u32x4*)((const char*)Vb + off_); } \
            { const int ks_ = start + 32 * (step) + (lane & 31); const int kc_ = ks_ < 0 ? 0 : (ks_ >= L ? L - 1 : ks_); \
                rks = *(const float*)((const char*)ssq + ((unsigned)((16 + h) * 4) * MTOK + (unsigned)(seq_start + res + (kc_ << dsh))) * 4u); } } while (0)
        ATT_LOAD(0);
#pragma unroll 1
        for (int step = 0; step < 5; ++step) {
#pragma unroll
            for (int i = 0; i < 8; ++i) {
                *(LAS u32x4*)(kt + WB(i & 3) + 2048 * (i >> 1) + 256 * (i & 1)) = kreg[i];
                *(LAS u32x4*)(vt + WB((2 * (i & 3) + (i >> 2)) & 3) + 2048 * (i & 3) + 256 * (i >> 2)) = vreg[i]; }
            if (lane < 32) { const int ks_ = start + 32 * step + lane;
                rkb[lane] = rks; kng[lane] = (ks_ >= 0 && ks_ < L) ? 0.f : -1e30f; }
            if (step < 4) ATT_LOAD(step + 1);
            f32x4 st[2][2];
#pragma unroll
            for (int gq = 0; gq < 2; ++gq) { st[gq][0] = (f32x4){0.f, 0.f, 0.f, 0.f}; st[gq][1] = (f32x4){0.f, 0.f, 0.f, 0.f}; }
#pragma unroll
            for (int s = 0; s < 4; ++s) {
                const bf16x8 k0 = *(const LAS bf16x8*)(kt + kbase + 512 * s);
                const bf16x8 k1 = *(const LAS bf16x8*)(kt + kbase + 512 * s + 4096);
#pragma unroll
                for (int gq = 0; gq < 2; ++gq) {
                    st[gq][0] = __builtin_amdgcn_mfma_f32_16x16x32_bf16(k0, qf[gq][s], st[gq][0], 0, 0, 0);
                    st[gq][1] = __builtin_amdgcn_mfma_f32_16x16x32_bf16(k1, qf[gq][s], st[gq][1], 0, 0, 0);
                }
            }
            const f32x4 rk0 = *(const LAS f32x4*)(rkb + 4 * fq), rk1 = *(const LAS f32x4*)(rkb + 16 + 4 * fq);
            const f32x4 kn0 = *(const LAS f32x4*)(kng + 4 * fq), kn1 = *(const LAS f32x4*)(kng + 16 + 4 * fq);
            float bq[3][4];
            { const LAS float* bp = btp + (32 * step + 4 * fq - fr + 32);
#pragma unroll
              for (int j = 0; j < 4; ++j) { bq[0][j] = bp[j - 16]; bq[1][j] = bp[j]; bq[2][j] = bp[j + 16]; } }
            bf16x8 pf[2];
#pragma unroll
            for (int gq = 0; gq < 2; ++gq) {
                float p[8];
#pragma unroll
                for (int aa = 0; aa < 2; ++aa)
#pragma unroll
                    for (int j = 0; j < 4; ++j) {
                        const float b = bq[1 + aa - gq][j] + (aa == 0 ? kn0[j] : kn1[j]);
                        const float t = st[gq][aa][j] * (aa == 0 ? rk0[j] : rk1[j]);
                        const float pv = __builtin_amdgcn_exp2f(__builtin_fmaf(t, rq[gq], b));
                        p[4 * aa + j] = pv; den[gq] += pv;
                    }
                u32x4 pw = {cvt_pk_bf16(p[0], p[1]), cvt_pk_bf16(p[2], p[3]), cvt_pk_bf16(p[4], p[5]), cvt_pk_bf16(p[6], p[7])};
                pf[gq] = __builtin_bit_cast(bf16x8, pw);
            }
#pragma unroll
            for (int c = 0; c < 8; ++c) {
                const s16x4 lo = __builtin_amdgcn_ds_read_tr16_b64_v4i16((LAS s16x4*)(vt + TB(c & 1, 0) + 512 * (c >> 1)));
                const s16x4 hi = __builtin_amdgcn_ds_read_tr16_b64_v4i16((LAS s16x4*)(vt + TB(c & 1, 1) + 512 * (c >> 1)));
                const bf16x8 vf = {lo[0], lo[1], lo[2], lo[3], hi[0], hi[1], hi[2], hi[3]};
                o[0][c] = __builtin_amdgcn_mfma_f32_16x16x32_bf16(vf, pf[0], o[0][c], 0, 0, 0);
                o[1][c] = __builtin_amdgcn_mfma_f32_16x16x32_bf16(vf, pf[1], o[1][c], 0, 0, 0);
            }
        }
#undef ATT_LOAD
#pragma unroll
        for (int gq = 0; gq < 2; ++gq) { den[gq] += __shfl_xor(den[gq], 16); den[gq] += __shfl_xor(den[gq], 32); }
        if (pi < 2) {
#pragma unroll
            for (int gq = 0; gq < 2; ++gq) {
                const int qi = qpos[gq] - Pu;
                const unsigned xo = ((unsigned)(pi * 512 + qi) * 128 + 4 * fq) * 2u;
#pragma unroll
                for (int c = 0; c < 8; ++c) { u32x2 w; w.x = cvt_pk_bf16(o[gq][c][0], o[gq][c][1]); w.y = cvt_pk_bf16(o[gq][c][2], o[gq][c][3]); *(u32x2*)((char*)X + xo + 32 * c) = w; }
                if (fq == 0) *(float*)((char*)Xd + (unsigned)(pi * 512 + qi) * 4u) = den[gq];
            }
        } else {
            if (pass == 4) __syncthreads();
#pragma unroll
            for (int gq = 0; gq < 2; ++gq) {
                const int qi = qpos[gq] - Pu;
                const float dt = den[gq] + *(const float*)((const char*)Xd + (unsigned)qi * 4u) + *(const float*)((const char*)Xd + (unsigned)(512 + qi) * 4u);
                const float inv = 1.0f / dt;
                const unsigned x1o = ((unsigned)qi * 128 + 4 * fq) * 2u, x4o = ((unsigned)(512 + qi) * 128 + 4 * fq) * 2u;
                const unsigned go = ((unsigned)(seq_start + qpos[gq]) * AW + h * 128 + 4 * fq) * 2u;
#pragma unroll
                for (int c = 0; c < 8; ++c) {
                    bf16_t* gp = (bf16_t*)((char*)GA + go) - 16 * c + 16 * c;
                    const u32x2 xa = *(const u32x2*)((const char*)X + x1o + 32 * c), xb = *(const u32x2*)((const char*)X + x4o + 32 * c);
                    const f32x4 t = o[gq][c] + (f32x4){bflo(xa.x), bfhi(xa.x), bflo(xa.y), bfhi(xa.y)} + (f32x4){bflo(xb.x), bfhi(xb.x), bflo(xb.y), bfhi(xb.y)};
                    const u32x2 gg = *(const u32x2*)(gp + 16 * c);
                    u32x2 w; w.x = cvt_pk_bf16(t[0] * inv * bflo(gg.x), t[1] * inv * bfhi(gg.x)); w.y = cvt_pk_bf16(t[2] * inv * bflo(gg.y), t[3] * inv * bfhi(gg.y));
                    if (!DRY || inv == 1.2345e33f) *(u32x2*)(gp + 16 * c) = w;
                }
            }
        }
    }
    __syncthreads();
}

#define XB_TMO      128
#define XB_XCNT(j)  (256  + 64 * (j))
#define XB_XSUB(j)  (1280 + 64 * (j))
#define XB_XGEN(j)  (2304 + 64 * (j))
#define XB_TOP      3328
#define XB_TOPGEN   3392
#define XCD_BAR_WORDS 3456
#define XB_SPIN_CAP (1u << 20)
__device__ __forceinline__ unsigned xb_ld(unsigned* p)              { return __hip_atomic_load(p, __ATOMIC_RELAXED, __HIP_MEMORY_SCOPE_AGENT); }
__device__ __forceinline__ unsigned xb_add(unsigned* p, unsigned v) { return __hip_atomic_fetch_add(p, v, __ATOMIC_RELAXED, __HIP_MEMORY_SCOPE_AGENT); }
__device__ __forceinline__ unsigned xb_xcc_id() { return (unsigned)__builtin_amdgcn_s_getreg((3 << 11) | 20) & 0xFu; }
#define XB_SPIN(cond, bar) do { unsigned _sp = 0; while (cond) { __builtin_amdgcn_s_sleep(1); \
    if ((++_sp & 255u) == 0u) { if (xb_ld(&(bar)[XB_TMO])) break; if (_sp > XB_SPIN_CAP) { atomicAdd(&(bar)[XB_TMO], 1u); break; } } } } while (0)
struct XcdBarrier { unsigned* bar; unsigned x; volatile LAS unsigned* st; };
__device__ __forceinline__ XcdBarrier xcd_barrier_post(unsigned* bar, volatile LAS unsigned* st) {
    XcdBarrier b; b.bar = bar; b.x = xb_xcc_id(); b.st = st;
    if (threadIdx.x == 0) (void)xb_add(&bar[XB_XCNT(b.x)], 1u);
    return b;
}
__device__ __forceinline__ void xcd_barrier_complete(unsigned* bar, unsigned x, unsigned& nloc, unsigned& nx) {
    const unsigned G = gridDim.x * gridDim.y * gridDim.z;
    unsigned sum, cnt, mine, sp = 0u;
    for (;;) {
        sum = 0u; cnt = 0u; mine = 0u;
#pragma unroll
        for (unsigned j = 0; j < 16; ++j) { const unsigned c = xb_ld(&bar[XB_XCNT(j)]); sum += c; cnt += (c > 0u) ? 1u : 0u; mine = (j == x) ? c : mine; }
        if (sum == G) break;
        __builtin_amdgcn_s_sleep(1);
        if ((++sp & 255u) == 0u) { if (xb_ld(&bar[XB_TMO])) break; if (sp > XB_SPIN_CAP) { atomicAdd(&bar[XB_TMO], 1u); break; } }
    }
    nloc = mine > 0u ? mine : 1u; nx = cnt > 0u ? cnt : 1u;
}
__device__ __forceinline__ void xcd_barrier(const XcdBarrier& b, int wave) {
    asm volatile("s_waitcnt vmcnt(0)" ::: "memory");
    __syncthreads();
    if (wave == 0 && __builtin_amdgcn_mbcnt_hi(~0u, __builtin_amdgcn_mbcnt_lo(~0u, (unsigned)wave)) == 0u) {
        unsigned* bar = b.bar;
        __builtin_amdgcn_s_waitcnt(0);
        unsigned nloc = b.st[0], nx = b.st[1];
        if (nloc == 0u) { xcd_barrier_complete(bar, b.x, nloc, nx); b.st[0] = nloc; b.st[1] = nx; }
        const unsigned old = xb_add(&bar[XB_XSUB(b.x)], 1u);
        const unsigned gen = old / nloc;
        if (old + 1u == (gen + 1u) * nloc) {
            __builtin_amdgcn_fence(__ATOMIC_RELEASE, "agent");
            asm volatile("s_waitcnt vmcnt(0)" ::: "memory");
            const unsigned og = xb_add(&bar[XB_TOP], 1u);
            const unsigned tg = og / nx;
            if (og + 1u == (tg + 1u) * nx) xb_add(&bar[XB_TOPGEN], 1u);
            else XB_SPIN(xb_ld(&bar[XB_TOPGEN]) == tg, bar);
            __builtin_amdgcn_fence(__ATOMIC_ACQUIRE, "agent");
            xb_add(&bar[XB_XGEN(b.x)], 1u);
            asm volatile("s_waitcnt vmcnt(0)" ::: "memory");
        } else {
            XB_SPIN(xb_ld(&bar[XB_XGEN(b.x)]) == gen, bar);
            __builtin_amdgcn_fence(__ATOMIC_ACQUIRE, "agent");
            asm volatile("s_waitcnt vmcnt(0)" ::: "memory");
        }
    }
    __syncthreads();
}

__global__ void __launch_bounds__(512, 2) fwd_kernel(Args args) {
    extern __shared__ __attribute__((aligned(16))) unsigned char lds_raw[];
    LAS unsigned char* lds = (LAS unsigned char*)lds_raw;
    cg::grid_group grid = cg::this_grid();
    const int tid = threadIdx.x, lane = tid & 63, wave = __builtin_amdgcn_readfirstlane(tid >> 6);
    const int G = gridDim.x;
    const int lo = args.ph_lo, hi = args.ph_hi;
#define IN(k) (lo <= (k) && (k) < hi)
#define SEAM(k) do { if (IN(k) && IN((k) + 1)) { if (MK_SPLIT) grid.sync(); else xcd_barrier(xbar, wave); } } while (0)
    unsigned* barw = (unsigned*)(args.ws + WS_BAR);
    volatile LAS unsigned* bst = (volatile LAS unsigned*)(lds + LDS_BARW);
    if (tid < 2) bst[tid] = 0u;
    __syncthreads();
    if (args.ph_hi > 1000) grid.sync();
    XcdBarrier xbar; xbar.bar = barw; xbar.x = 0; xbar.st = bst;
    if (!MK_SPLIT) xbar = xcd_barrier_post(barw, bst);
    unsigned char* ws = args.ws;
    bf16_t* XB = (bf16_t*)((unsigned char*)args.out + DO_XB); bf16_t* YG = (bf16_t*)((unsigned char*)args.out + DO_YG);

    if (IN(0)) { p0_prologue(args, lds, tid, lane, wave); }
#if PROBE_DUP == 1
    __syncthreads(); p0_prologue(args, lds, tid, lane, wave);
#endif
    SEAM(0);
    if (IN(1)) {
        pg8::Gemm g{XB, (const bf16_t*)(ws + WS_WIN), MTOK, NIN, DM}; pg8::StaticOrder S; S.init(MTOK, NIN, G, (int)blockIdx.x);
        pg8::EpiIn E{(const float*)(ws + WS_RINV), (const float*)(ws + WS_QKG), (float*)(ws + WS_SSQ), (bf16_t*)(ws + WS_Q), (bf16_t*)(ws + WS_K), (bf16_t*)(ws + WS_V), (bf16_t*)(ws + WS_GA),
                     (bf16_t*)(ws + WS_UG), (bf16_t*)(ws + WS_GB), (bf16_t*)(ws + WS_MA), (bf16_t*)(ws + WS_MB)};
        pg8::gemm_phase<pg8::EpiIn, pg8::StaticOrder, true, true>(lds, g, S, E, wave);
#if PROBE_DUP == 2
        pg8::gemm_phase<pg8::EpiIn, pg8::StaticOrder, true, true>(lds, g, S, E, wave);
#endif
    }
    SEAM(1);
    if (IN(2)) {
        {
            pg8::Gemm g{(const bf16_t*)(ws + WS_UG), (const bf16_t*)(ws + WS_SWS), NGRP * 1536, NGRP * 256, 256};
            pg8::GroupOrder S{G, (int)blockIdx.x};
            pg8::EpiE E{(bf16_t*)((unsigned char*)args.out + DO_EG)};
            pg8::gemm_phase<pg8::EpiE, pg8::GroupOrder, true, true>(lds, g, S, E, wave);
        }
        {
            float* sp = (float*)(ws + WS_SSQ);
            const int t0 = (int)blockIdx.x * 512 + wave * 64 + (int)__builtin_amdgcn_mbcnt_hi(~0u, __builtin_amdgcn_mbcnt_lo(~0u, (unsigned)wave)) - wave;
            for (int idx = t0; idx < 32 * MTOK; idx += G * 512) {
                const int hd = idx / MTOK, tok = idx - hd * MTOK;
                float* p0 = sp + (size_t)(hd * 4) * MTOK + tok;
                const float ssum = (p0[0] + p0[MTOK]) + (p0[2 * MTOK] + p0[3 * MTOK]);
                const float r = 1.0f / sqrtf(ssum * (1.0f / 128.0f) + EPSN);
                p0[0] = hd < 16 ? r * LOG2E : r;
            }
        }
        if (!MK_SPLIT) xcd_barrier(xbar, wave);
        int lane_p2 = (int)__builtin_amdgcn_mbcnt_hi(~0u, __builtin_amdgcn_mbcnt_lo(~0u, 0u)); asm volatile("" : "+v"(lane_p2));
        const int lane = lane_p2;
        for (int sc = blockIdx.x * 4 + wave; wave < 4 && sc < 1024; sc += G * 4) ssm_scan(args, sc, lane);
#if PROBE_DUP == 6
        for (int au = blockIdx.x; au < 768; au += G) attn_unit<true>(args, lds, au >> 4, au & 15, lane, wave);
#endif
        for (int au = blockIdx.x; au < 768; au += G) attn_unit<false>(args, lds, au >> 4, au & 15, lane, wave);
    }
    SEAM(2);
    if (IN(3)) {
        {
            pg8::Gemm g{(const bf16_t*)(ws + WS_UG), (const bf16_t*)(ws + WS_SWY), NGRP * 1536, NGRP * 256, 512, (const bf16_t*)((unsigned char*)args.out + DO_HG), 4, 256};
            pg8::GroupOrder S{G, (int)blockIdx.x};
            pg8::EpiY E{(const bf16_t*)(ws + WS_UG), args.in[14], YG};
            pg8::gemm_phase<pg8::EpiY, pg8::GroupOrder, true, true, true>(lds, g, S, E, wave);
        }
        if (!MK_SPLIT) xcd_barrier(xbar, wave);
        { pg8::Gemm g{YG, (const bf16_t*)(ws + WS_WGLU), MTOK, 4096, SW}; pg8::StaticOrder S; S.init(MTOK, 4096, G, (int)blockIdx.x);
          pg8::EpiEw<0> E{(bf16_t*)(ws + WS_GB), nullptr, nullptr, nullptr, nullptr};
          pg8::gemm_phase<pg8::EpiEw<0>, pg8::StaticOrder, true, true, false, true>(lds, g, S, E, wave); }
    }
    SEAM(3);
    if (IN(4)) {
        pg8::Gemm g{(const bf16_t*)(ws + WS_GA), (const bf16_t*)(ws + WS_WA), MTOK, DM, 4096, (const bf16_t*)(ws + WS_GB), 32, 2048}; pg8::StaticOrder S; S.init(MTOK, DM, G, (int)blockIdx.x);
        pg8::EpiMerge E{(bf16_t*)(ws + WS_MA), (const bf16_t*)(ws + WS_MB)};
        pg8::gemm_phase<pg8::EpiMerge, pg8::StaticOrder, true, true, true>(lds, g, S, E, wave);
    }
    SEAM(4);
    if (IN(5)) {
        pg8::Gemm g{(const bf16_t*)(ws + WS_MA), (const bf16_t*)(ws + WS_WO), MTOK, DM, DM}; pg8::StaticOrder S; S.init(MTOK, DM, G, (int)blockIdx.x);
        pg8::EpiEw<3> E{nullptr, nullptr, args.in[0], args.in[1], args.out};
        pg8::gemm_phase<pg8::EpiEw<3>, pg8::StaticOrder, true, true>(lds, g, S, E, wave);
#if PROBE_DUP == 4
        pg8::gemm_phase<pg8::EpiEw<3>, pg8::StaticOrder, true, true>(lds, g, S, E, wave);
#endif
    }
#undef IN
#undef SEAM
}

extern "C" void kernel_launch(void* const* d_in, const int* in_sizes, int n_in, void* d_out, int out_size, void* d_ws, size_t ws_size, hipStream_t stream) {
    static int grid = 0;
    if (grid == 0) {
        if (n_in != 19 || out_size != MTOK * DM || ws_size < WS_END) { fprintf(stderr, "kernel_launch: unexpected shapes: n_in %d out %d ws %zu (need %zu)\n", n_in, out_size, ws_size, (size_t)WS_END); grid = -1; return; }
        int dev = 0, cus = 0, per_cu = 0;
        hipGetDevice(&dev); hipDeviceGetAttribute(&cus, hipDeviceAttributeMultiprocessorCount, dev);
        if (hipFuncSetAttribute((const void*)fwd_kernel, hipFuncAttributeMaxDynamicSharedMemorySize, LDS_BYTES) != hipSuccess) { fprintf(stderr, "kernel_launch: hipFuncSetAttribute failed\n"); grid = -1; return; }
        if (hipOccupancyMaxActiveBlocksPerMultiprocessor(&per_cu, (const void*)fwd_kernel, 512, LDS_BYTES) != hipSuccess || per_cu < 1) { fprintf(stderr, "kernel_launch: occupancy query says %d\n", per_cu); per_cu = 1; }
        (void)hipGetLastError();
        grid = cus * 1;
        (void)per_cu;
    }
    if (grid < 0) return;
    Args a{};
    for (int i = 0; i < 19; ++i) a.in[i] = (const float*)d_in[i];
    a.out = (float*)d_out; a.ws = (unsigned char*)d_ws;
#if MK_SPLIT
    for (int ph = 0; ph < 6; ++ph) {
        a.ph_lo = ph; a.ph_hi = ph + 1;
        hipLaunchKernelGGL(fwd_kernel, dim3(grid), dim3(512), LDS_BYTES, stream, a);
    }
#else
    a.ph_lo = 0; a.ph_hi = 6;
    if (hipMemsetAsync((char*)d_ws + WS_BAR, 0, XCD_BAR_WORDS * sizeof(unsigned), stream) != hipSuccess) { fprintf(stderr, "kernel_launch: hipMemsetAsync of the barrier words failed\n"); return; }
    void* kargs[] = {&a};
    hipError_t e = hipLaunchCooperativeKernel((const void*)fwd_kernel, dim3(grid), dim3(512), kargs, LDS_BYTES, stream);
    if (e != hipSuccess) fprintf(stderr, "kernel_launch: cooperative launch failed: %s (grid %d)\n", hipGetErrorString(e), grid);
#endif
}
```
